# Optimizing an MI355X kernel written in HIP

```python
import math
import jax, jax.numpy as jnp
from jax import lax
import numpy as np

D_MODEL = 1024
BATCH = 8
SEQ = 4096
DEPTH = 2

N_MIXERS = 2
N_GLA_LAYERS = (DEPTH + 1) // 2
N_DIFF_LAYERS = DEPTH // 2
BRANCH = 2 * D_MODEL
EPS = 1e-6

GLA_HEADS = 4
GLA_DK = D_MODEL // 2 // GLA_HEADS
GLA_DV = BRANCH // GLA_HEADS
GLA_RANK = 16
GLA_GATE_NORM = 16.0
GLA_CHUNK = 64
GLA_QK = GLA_HEADS * GLA_DK
GLA_IN = 2 * GLA_QK + 2 * BRANCH + GLA_RANK

DIFF_HEAD_DIM = 64
DIFF_HEADS = BRANCH // (2 * DIFF_HEAD_DIM)
DIFF_QBLOCK = 128
DIFF_IN = 4 * BRANCH
ROPE_THETA = 10000.0
LAMBDA_STD = 0.1

kernel_name = "hybrid_gla_diffattn_interleaved"


def rms_norm(x, g):
    xf = x.astype(jnp.float32)
    y = xf * lax.rsqrt(jnp.mean(xf * xf, axis=-1, keepdims=True) + EPS)
    return (y * g.astype(jnp.float32)).astype(x.dtype)


def rope_tables(T, d):
    inv_freq = 1.0 / (ROPE_THETA ** (jnp.arange(0, d, 2, dtype=jnp.float32) / d))
    pos = jnp.arange(T, dtype=jnp.float32)
    ang = pos[:, None] * inv_freq[None, :]
    return jnp.cos(ang), jnp.sin(ang)


def apply_rope(t, cos, sin):
    c = cos[:, None, None, :]
    s = sin[:, None, None, :]
    t1, t2 = jnp.split(t, 2, axis=-1)
    return jnp.concatenate([t1 * c - t2 * s, t2 * c + t1 * s], axis=-1)


def gla_mixer(h, w_in, w_g2, b_g, norm_g, w_out):
    B, T, _ = h.shape
    C = GLA_CHUNK
    N = T // C
    proj = h @ w_in
    q, k, v, gate, low = jnp.split(
        proj, [GLA_QK, 2 * GLA_QK, 2 * GLA_QK + BRANCH, 2 * GLA_QK + 2 * BRANCH], axis=-1)
    f32 = jnp.float32
    q = q.astype(f32).reshape(B, N, C, GLA_HEADS, GLA_DK) * (GLA_DK ** -0.5)
    k = k.astype(f32).reshape(B, N, C, GLA_HEADS, GLA_DK)
    v = v.astype(f32).reshape(B, N, C, GLA_HEADS, GLA_DV)
    logg = jax.nn.log_sigmoid((low @ w_g2 + b_g).astype(f32)) / GLA_GATE_NORM
    logg = logg.reshape(B, N, C, GLA_HEADS, GLA_DK)
    bcum = jnp.cumsum(logg, axis=2)
    blast = bcum[:, :, -1]
    q_t = q * jnp.exp(bcum)
    k_t = k * jnp.exp(-bcum)
    k_end = k * jnp.exp(blast[:, :, None] - bcum)
    causal = jnp.tril(jnp.ones((C, C), dtype=bool))
    A = jnp.einsum('bnihk,bnjhk->bnhij', q_t, k_t)
    A = jnp.where(causal, A, 0.0)
    o_intra = jnp.einsum('bnhij,bnjhv->bnihv', A, v)

    def step(S, inp):
        qn, kn, vn, dn = inp
        o = jnp.einsum('bihk,bhkv->bihv', qn, S)
        S = dn[..., None] * S + jnp.einsum('bjhk,bjhv->bhkv', kn, vn)
        return S, o

    xs = (jnp.moveaxis(q_t, 1, 0), jnp.moveaxis(k_end, 1, 0),
          jnp.moveaxis(v, 1, 0), jnp.moveaxis(jnp.exp(blast), 1, 0))
    S0 = jnp.zeros((B, GLA_HEADS, GLA_DK, GLA_DV), f32)
    _, o_inter = lax.scan(step, S0, xs)
    o = o_intra + jnp.moveaxis(o_inter, 0, 1)
    o = rms_norm(o.reshape(B, T, GLA_HEADS, GLA_DV), norm_g)
    o = o.reshape(B, T, BRANCH) * jax.nn.silu(gate.astype(f32))
    return o.astype(h.dtype) @ w_out


def diff_mixer(h, w_in, lq1, lk1, lq2, lk2, norm_g, w_out, lambda_init):
    B, T, _ = h.shape
    d = DIFF_HEAD_DIM
    f32 = jnp.float32
    proj = h @ w_in
    q, k, v, gate = jnp.split(proj, 4, axis=-1)
    cos, sin = rope_tables(T, d)
    q = apply_rope(q.astype(f32).reshape(B, T, DIFF_HEADS, 2, d), cos, sin)
    k = apply_rope(k.astype(f32).reshape(B, T, DIFF_HEADS, 2, d), cos, sin)
    v = v.astype(f32).reshape(B, T, DIFF_HEADS, 2 * d)
    lam = (jnp.exp(jnp.sum(lq1.astype(f32) * lk1.astype(f32)))
           - jnp.exp(jnp.sum(lq2.astype(f32) * lk2.astype(f32))) + lambda_init)
    qh = q.transpose(0, 2, 3, 1, 4)
    kh = k.transpose(0, 2, 3, 1, 4)
    vh = v.transpose(0, 2, 1, 3)
    scale = d ** -0.5
    outs = []
    for blk in range(T // DIFF_QBLOCK):
        s = blk * DIFF_QBLOCK
        e = s + DIFF_QBLOCK
        sc = jnp.einsum('bhcqd,bhckd->bhcqk', qh[:, :, :, s:e], kh[:, :, :, :e]) * scale
        causal = np.arange(e)[None, :] <= np.arange(s, e)[:, None]
        sc = jnp.where(causal, sc, -jnp.inf)
        p = jax.nn.softmax(sc, axis=-1)
        attn = p[:, :, 0] - lam * p[:, :, 1]
        outs.append(jnp.einsum('bhqk,bhkv->bhqv', attn, vh[:, :, :e]))
    o = jnp.concatenate(outs, axis=2)
    o = rms_norm(o, norm_g) * (1.0 - lambda_init)
    o = o.transpose(0, 2, 1, 3).reshape(B, T, BRANCH) * jax.nn.silu(gate.astype(f32))
    return o.astype(h.dtype) @ w_out


def setup_inputs(seed: int = 0) -> dict:
    key = jax.random.key(seed)
    ks = jax.random.split(key, 20)
    f32 = jnp.float32
    nrm = lambda k, shape, s: jax.random.normal(k, shape, f32) * s
    NG, ND = N_GLA_LAYERS, N_DIFF_LAYERS
    return {
        "x": jax.random.normal(ks[0], (BATCH, SEQ, D_MODEL), f32),
        "pre_g": 1.0 + nrm(ks[1], (DEPTH, D_MODEL), 0.02),
        "post_g": 1.0 + nrm(ks[2], (DEPTH, D_MODEL), 0.02),
        "gla_w_in": nrm(ks[3], (NG, D_MODEL, GLA_IN), D_MODEL ** -0.5),
        "gla_w_g2": nrm(ks[4], (NG, GLA_RANK, GLA_QK), GLA_RANK ** -0.5),
        "gla_b_g": nrm(ks[5], (NG, GLA_QK), 0.01),
        "gla_norm_g": 1.0 + nrm(ks[6], (NG, GLA_DV), 0.02),
        "gla_w_out": nrm(ks[7], (NG, BRANCH, D_MODEL), BRANCH ** -0.5),
        "diff_w_in": nrm(ks[8], (ND, D_MODEL, DIFF_IN), D_MODEL ** -0.5),
        "diff_lam_q1": nrm(ks[9], (ND, DIFF_HEAD_DIM), LAMBDA_STD),
        "diff_lam_k1": nrm(ks[10], (ND, DIFF_HEAD_DIM), LAMBDA_STD),
        "diff_lam_q2": nrm(ks[11], (ND, DIFF_HEAD_DIM), LAMBDA_STD),
        "diff_lam_k2": nrm(ks[12], (ND, DIFF_HEAD_DIM), LAMBDA_STD),
        "diff_norm_g": 1.0 + nrm(ks[13], (ND, 2 * DIFF_HEAD_DIM), 0.02),
        "diff_w_out": nrm(ks[14], (ND, BRANCH, D_MODEL), BRANCH ** -0.5),
    }


def reference(x, pre_g, post_g, gla_w_in, gla_w_g2, gla_b_g, gla_norm_g, gla_w_out,
              diff_w_in, diff_lam_q1, diff_lam_k1, diff_lam_q2, diff_lam_k2,
              diff_norm_g, diff_w_out):
    for i in range(DEPTH):
        h = rms_norm(x, pre_g[i])
        j = i // N_MIXERS
        if i % N_MIXERS == 0:
            y = gla_mixer(h, gla_w_in[j], gla_w_g2[j], gla_b_g[j], gla_norm_g[j], gla_w_out[j])
        else:
            lambda_init = 0.8 - 0.6 * math.exp(-0.3 * i)
            y = diff_mixer(h, diff_w_in[j], diff_lam_q1[j], diff_lam_k1[j], diff_lam_q2[j],
                           diff_lam_k2[j], diff_norm_g[j], diff_w_out[j], lambda_init)
        x = x + rms_norm(y, post_g[i])
    return x
```

```cpp
#include <hip/hip_runtime.h>
#include <cstdio>
#include <cstdint>
#include <cmath>

constexpr int T = 4096, DM = 1024, BR = 2048, NB = 8;
constexpr int GLA_IN = 5136, DIFF_IN = 8192;
constexpr float EPS = 1e-6f;

__global__ void __launch_bounds__(256) rms_rows(const float* x, const float* g, const float* res, float* out) {
    __shared__ float red[256];
    const int row = blockIdx.x, tid = threadIdx.x;
    const float* xr = x + (size_t)row * DM;
    float v[4]; float s = 0.f;
#pragma unroll
    for (int j = 0; j < 4; ++j) { v[j] = xr[tid + 256 * j]; s += v[j] * v[j]; }
    red[tid] = s; __syncthreads();
    for (int o = 128; o > 0; o >>= 1) { if (tid < o) red[tid] += red[tid + o]; __syncthreads(); }
    const float rstd = 1.0f / sqrtf(red[0] / DM + EPS);
#pragma unroll
    for (int j = 0; j < 4; ++j) { const int i = tid + 256 * j; float o = v[j] * rstd * g[i]; if (res) o += res[(size_t)row * DM + i]; out[(size_t)row * DM + i] = o; }
}

__global__ void __launch_bounds__(256) gemm_f32(const float* A, const float* B, float* C, int M, int N, int K, int lda, int ldb, int ldc) {
    __shared__ float As[16][65];
    __shared__ float Bs[16][65];
    const int tid = threadIdx.x, tx = tid & 15, ty = tid >> 4;
    const int m0 = blockIdx.y * 64, n0 = blockIdx.x * 64;
    float acc[4][4];
#pragma unroll
    for (int i = 0; i < 4; ++i)
#pragma unroll
        for (int j = 0; j < 4; ++j) acc[i][j] = 0.f;
    for (int k0 = 0; k0 < K; k0 += 16) {
#pragma unroll
        for (int e = 0; e < 4; ++e) { const int idx = tid + 256 * e; const int r = idx >> 4, c = idx & 15; As[c][r] = A[(size_t)(m0 + r) * lda + k0 + c]; }
#pragma unroll
        for (int e = 0; e < 4; ++e) { const int idx = tid + 256 * e; const int r = idx >> 6, c = idx & 63; const int n = n0 + c; Bs[r][c] = (n < N) ? B[(size_t)(k0 + r) * ldb + n] : 0.f; }
        __syncthreads();
#pragma unroll
        for (int kk = 0; kk < 16; ++kk) {
            float a[4], b[4];
#pragma unroll
            for (int i = 0; i < 4; ++i) a[i] = As[kk][ty * 4 + i];
#pragma unroll
            for (int j = 0; j < 4; ++j) b[j] = Bs[kk][tx + 16 * j];
#pragma unroll
            for (int i = 0; i < 4; ++i)
#pragma unroll
                for (int j = 0; j < 4; ++j) acc[i][j] += a[i] * b[j];
        }
        __syncthreads();
    }
#pragma unroll
    for (int i = 0; i < 4; ++i)
#pragma unroll
        for (int j = 0; j < 4; ++j) { const int n = n0 + tx + 16 * j; if (n < N) C[(size_t)(m0 + ty * 4 + i) * ldc + n] = acc[i][j]; }
}

__global__ void __launch_bounds__(256) gla_gates(const float* proj, const float* w_g2, const float* b_g, float* alpha) {
    const int idx = blockIdx.x * 256 + threadIdx.x; const int t = idx >> 9, c = idx & 511;
    float z = b_g[c];
#pragma unroll
    for (int r = 0; r < 16; ++r) z += proj[(size_t)t * GLA_IN + 5120 + r] * w_g2[r * 512 + c];
    const float ls = fminf(z, 0.f) - log1pf(expf(-fabsf(z)));
    alpha[idx] = expf(ls * (1.0f / 16.0f));
}

__global__ void __launch_bounds__(64) gla_recur(const float* proj, const float* alpha, float* o) {
    const int h = blockIdx.x >> 3, v = (blockIdx.x & 7) * 64 + threadIdx.x;
    float S[128];
#pragma unroll
    for (int k = 0; k < 128; ++k) S[k] = 0.f;
    const float scale = 0.08838834764831845f;
    for (int t = 0; t < T; ++t) {
        const float* pr = proj + (size_t)t * GLA_IN;
        const float* qv = pr + h * 128; const float* kv = pr + 512 + h * 128; const float* al = alpha + (size_t)t * 512 + h * 128;
        const float vv = pr[1024 + h * 512 + v];
        float acc = 0.f;
#pragma unroll
        for (int k = 0; k < 128; ++k) { S[k] = S[k] * al[k] + kv[k] * vv; acc += qv[k] * S[k]; }
        o[(size_t)t * BR + h * 512 + v] = acc * scale;
    }
}

__device__ __forceinline__ float silu_f(float z) { return z / (1.0f + expf(-z)); }

__global__ void __launch_bounds__(128) gla_post(const float* o, const float* proj, const float* norm_g, float* ap) {
    __shared__ float red[128];
    const int t = blockIdx.x >> 2, h = blockIdx.x & 3, tid = threadIdx.x;
    float v[4]; float s = 0.f;
#pragma unroll
    for (int j = 0; j < 4; ++j) { v[j] = o[(size_t)t * BR + h * 512 + tid + 128 * j]; s += v[j] * v[j]; }
    red[tid] = s; __syncthreads();
    for (int w = 64; w > 0; w >>= 1) { if (tid < w) red[tid] += red[tid + w]; __syncthreads(); }
    const float rstd = 1.0f / sqrtf(red[0] / 512.f + EPS);
#pragma unroll
    for (int j = 0; j < 4; ++j) { const int i = tid + 128 * j; const float gt = proj[(size_t)t * GLA_IN + 3072 + h * 512 + i];
        ap[(size_t)t * BR + h * 512 + i] = v[j] * rstd * norm_g[i] * silu_f(gt); }
}

__global__ void __launch_bounds__(256) rope_k(float* proj) {
    const int idx = blockIdx.x * 256 + threadIdx.x;
    const int j = idx & 31, c = (idx >> 5) & 1, hd = (idx >> 6) & 15, which = (idx >> 10) & 1, t = idx >> 11;
    const float inv_freq = 1.0f / powf(10000.0f, (float)j / 32.0f);
    const float ang = (float)t * inv_freq;
    const float cs = cosf(ang), sn = sinf(ang);
    float* p = proj + (size_t)t * DIFF_IN + which * 2048 + hd * 128 + c * 64 + j;
    const float x1 = p[0], x2 = p[32];
    p[0] = x1 * cs - x2 * sn; p[32] = x2 * cs + x1 * sn;
}

__global__ void __launch_bounds__(64) attn_naive(const float* proj, float* O0, float* O1) {
    const int qt = blockIdx.x, h = blockIdx.y, c = blockIdx.z;
    const int t = qt * 64 + threadIdx.x;
    float q[64];
#pragma unroll
    for (int d = 0; d < 64; ++d) q[d] = proj[(size_t)t * DIFF_IN + h * 128 + c * 64 + d] * 0.125f;
    float O[128];
#pragma unroll
    for (int d = 0; d < 128; ++d) O[d] = 0.f;
    float m = -INFINITY, l = 0.f;
    const int jend = qt * 64 + 64;
    for (int j = 0; j < jend; ++j) {
        const float* kr = proj + (size_t)j * DIFF_IN + 2048 + h * 128 + c * 64;
        const float* vr = proj + (size_t)j * DIFF_IN + 4096 + h * 128;
        float s = 0.f;
#pragma unroll
        for (int d = 0; d < 64; ++d) s += q[d] * kr[d];
        const bool ok = (j <= t);
        const float mn = ok ? fmaxf(m, s) : m;
        const float sc = expf(m - mn);
        const float p = ok ? expf(s - mn) : 0.f;
        l = l * sc + p;
#pragma unroll
        for (int d = 0; d < 128; ++d) O[d] = O[d] * sc + p * vr[d];
        m = mn;
    }
    float* Oc = (c == 0 ? O0 : O1) + (size_t)t * BR + h * 128;
    const float il = 1.0f / l;
#pragma unroll
    for (int d = 0; d < 128; ++d) Oc[d] = O[d] * il;
}

__global__ void __launch_bounds__(128) diff_post(const float* O0, const float* O1, const float* proj, const float* lq1, const float* lk1, const float* lq2, const float* lk2,
                                                 const float* norm_g, float* ap, float lambda_init) {
    __shared__ float red[128];
    const int t = blockIdx.x >> 4, h = blockIdx.x & 15, tid = threadIdx.x;
    float s1 = 0.f, s2 = 0.f;
    for (int i = 0; i < 64; ++i) { s1 += lq1[i] * lk1[i]; s2 += lq2[i] * lk2[i]; }
    const float lam = expf(s1) - expf(s2) + lambda_init;
    const size_t idx = (size_t)t * BR + h * 128 + tid;
    const float o = O0[idx] - lam * O1[idx];
    red[tid] = o * o; __syncthreads();
    for (int w = 64; w > 0; w >>= 1) { if (tid < w) red[tid] += red[tid + w]; __syncthreads(); }
    const float rstd = 1.0f / sqrtf(red[0] / 128.f + EPS);
    const float gt = proj[(size_t)t * DIFF_IN + 6144 + h * 128 + tid];
    ap[idx] = o * rstd * norm_g[tid] * (1.0f - lambda_init) * silu_f(gt);
}

extern "C" void kernel_launch(void* const* d_in, const int* in_sizes, int n_in, void* d_out, int out_size, void* d_ws, size_t ws_size, hipStream_t stream) {
    const float* x = (const float*)d_in[0]; const float* pre_g = (const float*)d_in[1]; const float* post_g = (const float*)d_in[2];
    const float* gla_w_in = (const float*)d_in[3]; const float* gla_w_g2 = (const float*)d_in[4]; const float* gla_b_g = (const float*)d_in[5];
    const float* gla_norm_g = (const float*)d_in[6]; const float* gla_w_out = (const float*)d_in[7];
    const float* diff_w_in = (const float*)d_in[8]; const float* lq1 = (const float*)d_in[9]; const float* lk1 = (const float*)d_in[10];
    const float* lq2 = (const float*)d_in[11]; const float* lk2 = (const float*)d_in[12]; const float* diff_norm_g = (const float*)d_in[13]; const float* diff_w_out = (const float*)d_in[14];
    float* out = (float*)d_out;
    char* ws = (char*)d_ws; const size_t MiB = 1u << 20;
    float* H = (float*)(ws + 0); float* PROJ = (float*)(ws + 16 * MiB); float* GAT = (float*)(ws + 144 * MiB); float* O = (float*)(ws + 152 * MiB);
    float* O1 = (float*)(ws + 184 * MiB); float* AP = (float*)(ws + 216 * MiB); float* Y = (float*)(ws + 248 * MiB);
    const float lambda_init = (float)(0.8 - 0.6 * exp(-0.3 * 1.0));
    for (int b = 0; b < NB; ++b) {
        const float* xb = x + (size_t)b * T * DM; float* ob = out + (size_t)b * T * DM;
        rms_rows<<<T, 256, 0, stream>>>(xb, pre_g, nullptr, H);
        gemm_f32<<<dim3((GLA_IN + 63) / 64, T / 64), 256, 0, stream>>>(H, gla_w_in, PROJ, T, GLA_IN, DM, DM, GLA_IN, GLA_IN);
        gla_gates<<<T * 512 / 256, 256, 0, stream>>>(PROJ, gla_w_g2, gla_b_g, GAT);
        gla_recur<<<32, 64, 0, stream>>>(PROJ, GAT, O);
        gla_post<<<T * 4, 128, 0, stream>>>(O, PROJ, gla_norm_g, AP);
        gemm_f32<<<dim3(DM / 64, T / 64), 256, 0, stream>>>(AP, gla_w_out, Y, T, DM, BR, BR, DM, DM);
        rms_rows<<<T, 256, 0, stream>>>(Y, post_g, xb, ob);
        rms_rows<<<T, 256, 0, stream>>>(ob, pre_g + DM, nullptr, H);
        gemm_f32<<<dim3(DIFF_IN / 64, T / 64), 256, 0, stream>>>(H, diff_w_in, PROJ, T, DIFF_IN, DM, DM, DIFF_IN, DIFF_IN);
        rope_k<<<T * 2048 / 256, 256, 0, stream>>>(PROJ);
        attn_naive<<<dim3(T / 64, 16, 2), 64, 0, stream>>>(PROJ, O, O1);
        diff_post<<<T * 16, 128, 0, stream>>>(O, O1, PROJ, lq1, lk1, lq2, lk2, diff_norm_g, AP, lambda_init);
        gemm_f32<<<dim3(DM / 64, T / 64), 256, 0, stream>>>(AP, diff_w_out, Y, T, DM, BR, BR, DM, DM);
        rms_rows<<<T, 256, 0, stream>>>(Y, post_g + DM, ob, ob);
    }
}
```

```cpp
#include <hip/hip_runtime.h>
#include <cstdio>
#include <cstdint>
#include <cmath>
namespace pg8 {
#define PG8_LAS __attribute__((address_space(3)))
typedef unsigned short bf16_t;
typedef short bf16x8 __attribute__((ext_vector_type(8)));
typedef float f32x4 __attribute__((ext_vector_type(4)));
typedef unsigned u32x4 __attribute__((ext_vector_type(4)));
constexpr int BM = 256, BK = 64, HALF = 128, HTB = HALF * BK * 2  , STAGE_BYTES = 8 * HTB, NXCD = 8, WGM = 8;

__host__ __device__ __forceinline__ int lds_byte(int r, int c) { const int st = (r >> 4) * 2 + (c >> 5), rr = r & 15, cc = c & 31, ob = rr * 64 + cc * 2; return st * 1024 + (ob ^ (((ob >> 9) & 1) << 5)); }
__host__ __device__ __forceinline__ void stage_rc(int b, int& R, int& C) { const int st = b / 1024, sb = b % 1024, swz = sb ^ (((sb >> 9) & 1) << 5); R = (st >> 1) * 16 + swz / 64; C = (st & 1) * 32 + (swz % 64) / 2; }
__host__ __device__ __forceinline__ int perm32(int rho) { const int n = rho >> 4, i = rho & 15; return 8 * (i >> 2) + 4 * n + (i & 3); }

struct Unit { int pm, pn; };
struct Gemm { const bf16_t* A; const bf16_t* Bt; int M, N, K; };

struct StaticOrder {
    int nM, nN, nwg, G, c;
    __host__ __device__ void init(int M, int N, int G_, int c_) { nM = M / BM; nN = N / BM; nwg = nM * nN; G = G_; c = c_; }
    __host__ __device__ bool next(int i, Unit& u) const {
        const long L = (long)i * G + c; if (L >= nwg) return false;
        int wgid = (int)L; { const int q = nwg / NXCD, r = nwg % NXCD, xcd = wgid % NXCD, off = wgid / NXCD; wgid = (xcd < r ? xcd * (q + 1) : r * (q + 1) + (xcd - r) * q) + off; }
        const int nig = WGM * nN, gid = wgid / nig, fm = gid * WGM, gsz = (nM - fm) < WGM ? (nM - fm) : WGM;
        u.pm = fm + ((wgid % nig) % gsz); u.pn = (wgid % nig) / gsz; return true;
    }
    __device__ __forceinline__ void a_ready(const Unit&) const {}
    __device__ __forceinline__ void done(const Unit&) const {}
};

__device__ __forceinline__ unsigned cvt_pk_bf16(float lo, float hi) { unsigned r; asm volatile("v_cvt_pk_bf16_f32 %0, %1, %2" : "=v"(r) : "v"(lo), "v"(hi)); return r; }
typedef float f32x2 __attribute__((ext_vector_type(2)));
template <class Epi, class Sched, bool ALIGN_EPI = false, bool SP2 = false>
__device__ __forceinline__ void gemm_phase(PG8_LAS unsigned char* lds, const Gemm g, const Sched& S, const Epi& E) {
    const int tid = threadIdx.x, wid = __builtin_amdgcn_readfirstlane(tid >> 6), lane = tid & 63, wr = wid >> 2, wc = wid & 3, fr = lane & 15, fq = lane >> 4;
    const int K = g.K, nt = K / BK;
    unsigned voffA[2], voffB[2];
#pragma unroll
    for (int i = 0; i < 2; ++i) { int R, C; stage_rc(tid * 16 + i * 8192, R, C); const int Rb = Epi::PERM ? ((R & ~31) + perm32(R & 31)) : R;
        voffA[i] = (unsigned)(R * K + C) * 2u; voffB[i] = (unsigned)(Rb * K + C) * 2u; }
    const size_t kstep = (size_t)(BK * 2);
    const size_t hstep = (size_t)HALF * K * 2;
    const size_t tstep = 2 * hstep;
    const unsigned ldsw = (unsigned)wid * 1024u;
    const int aoff = lds_byte(wr * 64 + fr, fq * 8), boff = lds_byte(wc * 32 + fr, fq * 8);
#define PG8_SA(b, h) (((b) * 2 + (h)) * HTB)
#define PG8_SB(b, h) ((4 + (b) * 2 + (h)) * HTB)
#define PG8_STAGE(bufoff, gbase, voff) do { _Pragma("unroll") for (int _i = 0; _i < 2; ++_i) \
        __builtin_amdgcn_global_load_lds((const unsigned*)((const char*)(gbase) + (voff)[_i]), (PG8_LAS unsigned*)(lds + (bufoff) + ldsw + _i * 8192), 16, 0, 0); } while (0)
#define PG8_LDA(dst, b, h) do { _Pragma("unroll") for (int m = 0; m < 4; ++m) _Pragma("unroll") for (int k = 0; k < 2; ++k) dst[m][k] = *(const PG8_LAS bf16x8*)(lds + PG8_SA(b, h) + aoff + m * 2048 + k * 1024); } while (0)
#define PG8_LDB(dst, b, h) do { _Pragma("unroll") for (int n = 0; n < 2; ++n) _Pragma("unroll") for (int k = 0; k < 2; ++k) dst[n][k] = *(const PG8_LAS bf16x8*)(lds + PG8_SB(b, h) + boff + n * 2048 + k * 1024); } while (0)
#define PG8_MMA(ai, bj, At, Bt) do { __builtin_amdgcn_s_setprio(1); _Pragma("unroll") for (int m = 0; m < 4; ++m) _Pragma("unroll") for (int n = 0; n < 2; ++n) _Pragma("unroll") for (int k = 0; k < 2; ++k) \
        acc[ai][bj][m][n] = __builtin_amdgcn_mfma_f32_16x16x32_bf16(Bt[n][k], At[m][k], acc[ai][bj][m][n], 0, 0, 0); __builtin_amdgcn_s_setprio(0); } while (0)
#define PG8_WAIT_V(n) asm volatile("s_waitcnt vmcnt(" #n ")" ::: "memory")
#define PG8_WAIT_L(n) asm volatile("s_waitcnt lgkmcnt(" #n ")" ::: "memory")
#define PG8_BAR __builtin_amdgcn_s_barrier()
#define PG8_SCHED __builtin_amdgcn_sched_barrier(0)
    Unit cur, nxt; int ui = 0;
    if (!S.next(0, cur)) return;
    f32x4 acc[2][2][4][2];
#pragma unroll
    for (int a = 0; a < 2; ++a)
#pragma unroll
        for (int b = 0; b < 2; ++b)
#pragma unroll
            for (int m = 0; m < 4; ++m)
#pragma unroll
                for (int n = 0; n < 2; ++n) acc[a][b][m][n] = (f32x4){0.f, 0.f, 0.f, 0.f};
    bf16x8 At[4][2], B0[2][2], B1[2][2];
    const char* cA = (const char*)g.A + (size_t)cur.pm * tstep; const char* cB = (const char*)g.Bt + (size_t)cur.pn * tstep;
    S.a_ready(cur);
    if constexpr (SP2) {
        PG8_STAGE(PG8_SB(0, 0), cB, voffB); PG8_STAGE(PG8_SB(0, 1), cB + hstep, voffB); PG8_STAGE(PG8_SA(0, 0), cA, voffA); PG8_STAGE(PG8_SA(0, 1), cA + hstep, voffA);
        if (wr == 1) PG8_BAR;
        PG8_WAIT_V(2); PG8_BAR;
        PG8_STAGE(PG8_SB(1, 0), cB + kstep, voffB); PG8_STAGE(PG8_SA(1, 0), cA + kstep, voffA); PG8_STAGE(PG8_SB(1, 1), cB + hstep + kstep, voffB);
        PG8_WAIT_V(6); PG8_BAR;
    } else {
        PG8_STAGE(PG8_SB(0, 0), cB, voffB); PG8_STAGE(PG8_SA(0, 0), cA, voffA); PG8_STAGE(PG8_SB(0, 1), cB + hstep, voffB); PG8_STAGE(PG8_SA(0, 1), cA + hstep, voffA);
        if (wr == 1) PG8_BAR;
        PG8_WAIT_V(4); PG8_BAR;
        PG8_STAGE(PG8_SB(1, 0), cB + kstep, voffB); PG8_STAGE(PG8_SA(1, 0), cA + kstep, voffA); PG8_STAGE(PG8_SB(1, 1), cB + hstep + kstep, voffB);
        PG8_WAIT_V(6); PG8_BAR;
    }
    for (;;) {
        const bool has_next = S.next(ui + 1, nxt);
        const char* nA = has_next ? (const char*)g.A + (size_t)nxt.pm * tstep : cA; const char* nB = has_next ? (const char*)g.Bt + (size_t)nxt.pn * tstep : cB;
        for (int t = 0; t < nt; t += 2) {
            const bool last = (t == nt - 2);
            const char* a1 = cA + (size_t)(t + 1) * kstep;
            const char* a2 = last ? nA : cA + (size_t)(t + 2) * kstep; const char* b2 = last ? nB : cB + (size_t)(t + 2) * kstep;
            const char* a3 = a2 + kstep; const char* b3 = b2 + kstep;
            if (last && has_next) S.a_ready(nxt);
            if constexpr (SP2) {
            PG8_LDB(B0, 0, 0); PG8_LDB(B1, 0, 1); PG8_SCHED; PG8_LDA(At, 0, 0); PG8_STAGE(PG8_SA(1, 1), a1 + hstep, voffA);
            PG8_WAIT_V(8); PG8_WAIT_L(0); PG8_BAR; PG8_MMA(0, 0, At, B0); PG8_MMA(0, 1, At, B1); PG8_BAR; PG8_SCHED;
            PG8_LDA(At, 0, 1); PG8_STAGE(PG8_SB(0, 0), b2, voffB); PG8_STAGE(PG8_SB(0, 1), b2 + hstep, voffB); PG8_STAGE(PG8_SA(0, 0), a2, voffA);
            PG8_WAIT_V(8); PG8_WAIT_L(0); PG8_BAR; PG8_MMA(1, 0, At, B0); PG8_MMA(1, 1, At, B1); PG8_BAR; PG8_SCHED;
            PG8_LDB(B0, 1, 0); PG8_LDB(B1, 1, 1); PG8_SCHED; PG8_LDA(At, 1, 0); PG8_STAGE(PG8_SA(0, 1), a2 + hstep, voffA);
            PG8_WAIT_V(8); PG8_WAIT_L(0); PG8_BAR; PG8_MMA(0, 0, At, B0); PG8_MMA(0, 1, At, B1); PG8_BAR; PG8_SCHED;
            PG8_LDA(At, 1, 1); PG8_STAGE(PG8_SB(1, 0), b3, voffB); PG8_STAGE(PG8_SB(1, 1), b3 + hstep, voffB); PG8_STAGE(PG8_SA(1, 0), a3, voffA);
            PG8_WAIT_V(8); PG8_WAIT_L(0); PG8_BAR; PG8_MMA(1, 0, At, B0); PG8_MMA(1, 1, At, B1); PG8_BAR; PG8_SCHED;
            } else {
            PG8_LDB(B0, 0, 0); PG8_SCHED; PG8_LDA(At, 0, 0); PG8_STAGE(PG8_SA(1, 1), a1 + hstep, voffA);
            PG8_WAIT_L(8); PG8_BAR; PG8_WAIT_L(0); PG8_MMA(0, 0, At, B0); PG8_BAR; PG8_SCHED;
            PG8_LDB(B1, 0, 1); PG8_STAGE(PG8_SB(0, 0), b2, voffB);
            PG8_BAR; PG8_WAIT_L(0); PG8_MMA(0, 1, At, B1); PG8_BAR;
            PG8_LDA(At, 0, 1); PG8_STAGE(PG8_SA(0, 0), a2, voffA);
            PG8_BAR; PG8_WAIT_L(0); PG8_MMA(1, 0, At, B0); PG8_BAR; PG8_SCHED;
            PG8_STAGE(PG8_SB(0, 1), b2 + hstep, voffB);
            PG8_WAIT_V(6); PG8_BAR; PG8_MMA(1, 1, At, B1); PG8_BAR;
            PG8_LDB(B0, 1, 0); PG8_SCHED; PG8_LDA(At, 1, 0); PG8_STAGE(PG8_SA(0, 1), a2 + hstep, voffA);
            PG8_WAIT_L(8); PG8_BAR; PG8_WAIT_L(0); PG8_MMA(0, 0, At, B0); PG8_BAR; PG8_SCHED;
            PG8_LDB(B1, 1, 1); PG8_STAGE(PG8_SB(1, 0), b3, voffB);
            PG8_BAR; PG8_WAIT_L(0); PG8_MMA(0, 1, At, B1); PG8_BAR;
            PG8_LDA(At, 1, 1); PG8_STAGE(PG8_SA(1, 0), a3, voffA);
            PG8_BAR; PG8_WAIT_L(0); PG8_MMA(1, 0, At, B0); PG8_BAR; PG8_SCHED;
            PG8_STAGE(PG8_SB(1, 1), b3 + hstep, voffB);
            PG8_WAIT_V(6); PG8_BAR; PG8_MMA(1, 1, At, B1); PG8_BAR;
            }
        }
        if constexpr (ALIGN_EPI) { if (wr == 0) PG8_BAR; }
        if constexpr (!Epi::AFTER_DRAIN) { E(acc, cur, wr, wc, fr, fq); S.done(cur); }
        if (!has_next) break;
#pragma unroll
        for (int a = 0; a < 2; ++a)
#pragma unroll
            for (int b = 0; b < 2; ++b)
#pragma unroll
                for (int m = 0; m < 4; ++m)
#pragma unroll
                    for (int n = 0; n < 2; ++n) acc[a][b][m][n] = (f32x4){0.f, 0.f, 0.f, 0.f};
        cur = nxt; cA = nA; cB = nB; ++ui;
        if constexpr (ALIGN_EPI) { if (wr == 1) PG8_BAR; }
    }
    PG8_WAIT_V(0);
    if constexpr (!ALIGN_EPI) { if (wr == 0) PG8_BAR; }
    PG8_BAR;
    if constexpr (Epi::AFTER_DRAIN) { E.fused(acc, cur, wr, wc, fr, fq, lds, wid, lane); S.done(cur); }
#undef PG8_SA
#undef PG8_SB
#undef PG8_STAGE
#undef PG8_LDA
#undef PG8_LDB
#undef PG8_MMA
#undef PG8_WAIT_V
#undef PG8_WAIT_L
#undef PG8_BAR
#undef PG8_SCHED
}
}
#define GAS __attribute__((address_space(1)))
#define LAS __attribute__((address_space(3)))
typedef unsigned short bf16;
typedef unsigned v4u __attribute__((ext_vector_type(4)));
typedef float f32x4 __attribute__((ext_vector_type(4)));
typedef short bf16x8 __attribute__((ext_vector_type(8)));
typedef GAS unsigned gu32;
typedef GAS unsigned long long gu64;
#define RLX_AGENT __ATOMIC_RELAXED, __HIP_MEMORY_SCOPE_AGENT
#define LDS_WAIT() asm volatile("s_waitcnt lgkmcnt(0)" ::: "memory")
#define VM_WAIT() asm volatile("s_waitcnt vmcnt(0)" ::: "memory")
__device__ __forceinline__ unsigned long long rt() { return __builtin_amdgcn_s_memrealtime(); }
__device__ __forceinline__ unsigned f2bf(float f) { unsigned u = __builtin_bit_cast(unsigned, f); return (u + 0x7fffu + ((u >> 16) & 1u)) >> 16; }
__device__ __forceinline__ unsigned pk2(float lo, float hi) { return f2bf(lo) | (f2bf(hi) << 16); }

#define XB_TMO      128
#define XB_XCNT(j)  (256  + 64 * (j))
#define XB_XSUB(j)  (1280 + 64 * (j))
#define XB_XGEN(j)  (2304 + 64 * (j))
#define XB_TOP      3328
#define XB_TOPGEN   3392
#define XCD_BAR_WORDS 3456
#define XB_SPIN_CAP (1u << 18)

__device__ __forceinline__ unsigned xb_ld(unsigned* p)              { return __hip_atomic_load(p, __ATOMIC_RELAXED, __HIP_MEMORY_SCOPE_AGENT); }
__device__ __forceinline__ unsigned xb_add(unsigned* p, unsigned v) { return __hip_atomic_fetch_add(p, v, __ATOMIC_RELAXED, __HIP_MEMORY_SCOPE_AGENT); }
__device__ __forceinline__ unsigned xb_xcc_id() { return (unsigned)__builtin_amdgcn_s_getreg((3 << 11) | 20) & 0xFu; }
#define XB_SPIN(cond, bar) do { unsigned _sp = 0; while (cond) { __builtin_amdgcn_s_sleep(1); \
    if ((++_sp & 255u) == 0u) { if (xb_ld(&(bar)[XB_TMO])) break; if (_sp > XB_SPIN_CAP) { atomicAdd(&(bar)[XB_TMO], 1u); break; } } } } while (0)

struct XcdBarrier {
    unsigned* bar; unsigned x;
    volatile LAS unsigned* st;
};

__device__ __forceinline__ XcdBarrier xcd_barrier_post(unsigned* bar, volatile LAS unsigned* st) {
    XcdBarrier b; b.bar = bar; b.x = xb_xcc_id(); b.st = st;
    if (threadIdx.x == 0) (void)xb_add(&bar[XB_XCNT(b.x)], 1u);
    return b;
}
__device__ __forceinline__ void xcd_barrier_complete(unsigned* bar, unsigned x, unsigned& nloc, unsigned& nx) {
    const unsigned G = gridDim.x * gridDim.y * gridDim.z;
    unsigned sum, cnt, mine, sp = 0u;
    for (;;) {
        sum = 0u; cnt = 0u; mine = 0u;
#pragma unroll
        for (unsigned j = 0; j < 16; ++j) { const unsigned c = xb_ld(&bar[XB_XCNT(j)]); sum += c; cnt += (c > 0u) ? 1u : 0u; mine = (j == x) ? c : mine; }
        if (sum == G) break;
        __builtin_amdgcn_s_sleep(1);
        if ((++sp & 255u) == 0u) { if (xb_ld(&bar[XB_TMO])) break; if (sp > XB_SPIN_CAP) { atomicAdd(&bar[XB_TMO], 1u); break; } }
    }
    nloc = mine > 0u ? mine : 1u; nx = cnt > 0u ? cnt : 1u;
}

__device__ __forceinline__ void xcd_barrier(const XcdBarrier& b) {
    asm volatile("s_waitcnt vmcnt(0)" ::: "memory");
    __syncthreads();
    if (threadIdx.x == 0) {
        unsigned* bar = b.bar;
        __builtin_amdgcn_s_waitcnt(0);
        unsigned nloc = b.st[0], nx = b.st[1];
        if (nloc == 0u) { xcd_barrier_complete(bar, b.x, nloc, nx); b.st[0] = nloc; b.st[1] = nx; }
        const unsigned old = xb_add(&bar[XB_XSUB(b.x)], 1u);
        const unsigned gen = old / nloc;
        if (old + 1u == (gen + 1u) * nloc) {
            __builtin_amdgcn_fence(__ATOMIC_RELEASE, "agent");
            asm volatile("s_waitcnt vmcnt(0)" ::: "memory");
            const unsigned og = xb_add(&bar[XB_TOP], 1u);
            const unsigned tg = og / nx;
            if (og + 1u == (tg + 1u) * nx) xb_add(&bar[XB_TOPGEN], 1u);
            else XB_SPIN(xb_ld(&bar[XB_TOPGEN]) == tg, bar);
            __builtin_amdgcn_fence(__ATOMIC_ACQUIRE, "agent");
            xb_add(&bar[XB_XGEN(b.x)], 1u);
            asm volatile("s_waitcnt vmcnt(0)" ::: "memory");
        } else {
            XB_SPIN(xb_ld(&bar[XB_XGEN(b.x)]) == gen, bar);
            __builtin_amdgcn_fence(__ATOMIC_ACQUIRE, "agent");
            asm volatile("s_waitcnt vmcnt(0)" ::: "memory");
        }
    }
    __syncthreads();
}

constexpr int NWAVES = 8;
constexpr int NB = 8, T = 4096, D = 1024, BR = 2048;
constexpr int M = NB * T;
constexpr int GLA_IN = 5136, GLA_INP = 5376;
constexpr int DIFF_IN = 8192;
constexpr float RMS_EPS = 1e-6f;
constexpr float Q0_SCALE = 0.08838834764831845f;
constexpr float ATT_C2 = 0.125f * 1.4426950408889634f;
constexpr size_t MiB = 1u << 20;
constexpr size_t WS_CTL = 0, CTL_ZERO_BYTES = 1 * MiB;
constexpr size_t WS_W0IN = 2 * MiB;
constexpr size_t WS_W0OUT = 13 * MiB;
constexpr size_t WS_W1IN = 17 * MiB;
constexpr size_t WS_W1OUT = 33 * MiB;
constexpr size_t WS_ROPE = 37 * MiB;
constexpr size_t WS_XCH = 38 * MiB;
constexpr size_t WS_SSQ = 42 * MiB;
constexpr size_t WS_LOW = 46 * MiB;
constexpr size_t WS_XN = 48 * MiB;
constexpr size_t WS_QK0 = 112 * MiB;
constexpr size_t WS_V0 = 176 * MiB;
constexpr size_t WS_G0 = 304 * MiB;
constexpr size_t WS_Q1 = 112 * MiB;
constexpr size_t WS_K1 = 240 * MiB;
constexpr size_t WS_V1 = 368 * MiB;
constexpr size_t WS_END = 512 * MiB;
constexpr int CW_TMO = 0, CW_CODE = 1;
constexpr int CW_BAR = 4096;
constexpr int MAX_LAUNCH = 12;
constexpr int CW_SEAM = 65536, SEAM_BANK = 128 * 64;
static_assert(CW_BAR + MAX_LAUNCH * 3456 <= CW_SEAM && (CW_SEAM + 4 * SEAM_BANK) * 4 <= (int)CTL_ZERO_BYTES, "CTL words");
constexpr int RING_OFF = 0, RING_BYTES = 131072;
constexpr int LDSCTL_OFF = RING_BYTES, MISC_OFF = LDSCTL_OFF + 320;
constexpr int LDS_BYTES = 147456;

__device__ __forceinline__ float bf2f(unsigned short h) { return __builtin_bit_cast(float, (unsigned)h << 16); }
__device__ __forceinline__ unsigned short f2bf_s(float f) { return (unsigned short)f2bf(f); }
__device__ __forceinline__ float silu_f(float z) { return z / (1.0f + __expf(-z)); }
__host__ __device__ __forceinline__ int swap45(int s) { return (s & ~48) | ((s & 16) << 1) | ((s & 32) >> 1); }
__host__ __device__ __forceinline__ int rope_src(int n) { return (n & ~63) | swap45(n & 63); }

struct Frame {
    LAS unsigned char* lds; volatile LAS unsigned* MISC; gu32* ctl;
    int tid, lane, wave, vcu, G;
    const float *x, *pre_g, *post_g, *gla_w_in, *gla_w_g2, *gla_b_g, *gla_norm_g, *gla_w_out, *diff_w_in, *lq1, *lk1, *lq2, *lk2, *diff_norm_g, *diff_w_out;
    float* out; unsigned char* ws;
    bf16 *W0IN, *W0OUT, *W1IN, *W1OUT, *XN, *QK0, *V0, *G0, *Q1, *K1, *V1;
    float *ROPE, *SSQ, *LOW;
};
__device__ __forceinline__ float wave_sum(float v) {
#pragma unroll
    for (int o = 1; o < 64; o <<= 1) v += __shfl_xor(v, o);
    return v;
}
template <int MODE>
__device__ __forceinline__ void p0_transpose_item(const float* W, int K, int Nsrc, int nblk, bf16* WT, LAS float* scr, int item, int lane) {
    const int kb = item / nblk, nb = item % nblk, k0 = 64 * kb, n0 = 32 * nb;
    const int n = n0 + (lane & 31);
    int src = n; if (MODE == 1) src = (n < Nsrc) ? n : -1; if (MODE == 2) src = (n < 4096) ? rope_src(n) : n;
#pragma unroll 8
    for (int i = 0; i < 32; ++i) { const int kk = 2 * i + (lane >> 5); scr[kk * 33 + (lane & 31)] = (src >= 0) ? W[(size_t)(k0 + kk) * Nsrc + src] : 0.f; }
    LDS_WAIT(); asm volatile("" ::: "memory");
    const int c = lane & 7;
#pragma unroll
    for (int j = 0; j < 4; ++j) { const int nn = (lane >> 3) + 8 * j; const LAS float* s = scr + (8 * c) * 33 + nn;
        v4u o; o.x = pk2(s[0 * 33], s[1 * 33]); o.y = pk2(s[2 * 33], s[3 * 33]); o.z = pk2(s[4 * 33], s[5 * 33]); o.w = pk2(s[6 * 33], s[7 * 33]);
        *(GAS v4u*)(WT + (size_t)(n0 + nn) * K + k0 + 8 * c) = o; }
    LDS_WAIT(); asm volatile("" ::: "memory");
}
__device__ __forceinline__ void rms_row_to_bf16(int lane, const float* xrow, const float* g, bf16* orow) {
    const GAS f32x4* xr = (const GAS f32x4*)xrow + lane; const GAS f32x4* gr = (const GAS f32x4*)g + lane;
    f32x4 v[4]; float s = 0.f;
#pragma unroll
    for (int j = 0; j < 4; ++j) { v[j] = xr[64 * j]; s += (v[j].x * v[j].x + v[j].y * v[j].y) + (v[j].z * v[j].z + v[j].w * v[j].w); }
    const float rstd = 1.f / sqrtf(wave_sum(s) * (1.f / D) + RMS_EPS);
    GAS unsigned long long* o8 = (GAS unsigned long long*)orow + lane;
#pragma unroll
    for (int j = 0; j < 4; ++j) { const f32x4 gg = gr[64 * j];
        o8[64 * j] = (unsigned long long)pk2(v[j].x * rstd * gg.x, v[j].y * rstd * gg.y) | ((unsigned long long)pk2(v[j].z * rstd * gg.z, v[j].w * rstd * gg.w) << 32); }
}
__device__ __forceinline__ void p0_prologue(Frame& F) {
    LAS float* scr = (LAS float*)(F.lds + RING_OFF + F.wave * 16384);
    const int gw = F.vcu * NWAVES + F.wave, NGW = F.G * NWAVES;
    constexpr int I_0IN = (D / 64) * (GLA_INP / 32), I_OUT = (BR / 64) * (D / 32), I_1IN = (D / 64) * (DIFF_IN / 32);
    constexpr int NITEMS = I_0IN + I_OUT + I_1IN + I_OUT;
    for (int it = gw; it < NITEMS; it += NGW) {
        int r = it;
        if (r < I_0IN) { p0_transpose_item<1>(F.gla_w_in, D, GLA_IN, GLA_INP / 32, F.W0IN, scr, r, F.lane); continue; } r -= I_0IN;
        if (r < I_OUT) { p0_transpose_item<0>(F.gla_w_out, BR, D, D / 32, F.W0OUT, scr, r, F.lane); continue; } r -= I_OUT;
        if (r < I_1IN) { p0_transpose_item<2>(F.diff_w_in, D, DIFF_IN, DIFF_IN / 32, F.W1IN, scr, r, F.lane); continue; } r -= I_1IN;
        p0_transpose_item<0>(F.diff_w_out, BR, D, D / 32, F.W1OUT, scr, r, F.lane);
    }
    for (int m = gw; m < M; m += NGW) rms_row_to_bf16(F.lane, F.x + (size_t)m * D, F.pre_g, F.XN + (size_t)m * D);
    for (int i = (F.vcu * NWAVES + F.wave) * 64 + F.lane; i < T * 32; i += F.G * NWAVES * 64) {
        const int pos = i >> 5, j = i & 31;
        const float inv_freq = 1.0f / powf(10000.0f, (float)j / 32.0f);
        const float ang = (float)pos * inv_freq;
        F.ROPE[i] = cosf(ang); F.ROPE[T * 32 + i] = sinf(ang);
    }
}
namespace nv {
template <class Epi>
__global__ void __launch_bounds__(256) ngemm(const bf16* A, const bf16* Bt, int K, Epi epi) {
    __shared__ float As[32][65];
    __shared__ float Bs[32][65];
    const int tid = threadIdx.x, tx = tid & 15, ty = tid >> 4;
    const int m0 = blockIdx.y * 64, n0 = blockIdx.x * 64;
    float acc[4][4];
#pragma unroll
    for (int i = 0; i < 4; ++i)
#pragma unroll
        for (int j = 0; j < 4; ++j) acc[i][j] = 0.f;
    for (int k0 = 0; k0 < K; k0 += 32) {
#pragma unroll
        for (int e = 0; e < 8; ++e) { const int idx = tid + 256 * e; const int r = idx >> 5, c = idx & 31;
            As[c][r] = bf2f(A[(size_t)(m0 + r) * K + k0 + c]); Bs[c][r] = bf2f(Bt[(size_t)(n0 + r) * K + k0 + c]); }
        __syncthreads();
#pragma unroll
        for (int kk = 0; kk < 32; ++kk) {
            float a[4], b[4];
#pragma unroll
            for (int i = 0; i < 4; ++i) a[i] = As[kk][ty * 4 + i];
#pragma unroll
            for (int j = 0; j < 4; ++j) b[j] = Bs[kk][tx + 16 * j];
#pragma unroll
            for (int i = 0; i < 4; ++i)
#pragma unroll
                for (int j = 0; j < 4; ++j) acc[i][j] += a[i] * b[j];
        }
        __syncthreads();
    }
#pragma unroll
    for (int i = 0; i < 4; ++i)
#pragma unroll
        for (int j = 0; j < 4; ++j) epi(m0 + ty * 4 + i, n0 + tx + 16 * j, acc[i][j]);
}
struct E1 { bf16* QK0; bf16* V0; bf16* G0; float* LOW;
    __device__ void operator()(int m, int n, float a) const {
        if (n < 512) QK0[(size_t)m * 1024 + n] = f2bf_s(a * Q0_SCALE);
        else if (n < 1024) QK0[(size_t)m * 1024 + n] = f2bf_s(a);
        else if (n < 3072) V0[(size_t)m * 2048 + n - 1024] = f2bf_s(a);
        else if (n < 5120) G0[(size_t)m * 2048 + n - 3072] = f2bf_s(silu_f(a));
        else if (n < 5136) LOW[(size_t)m * 16 + n - 5120] = a; } };
struct EY { float* Y; __device__ void operator()(int m, int n, float a) const { Y[(size_t)m * 1024 + n] = a; } };
struct E4 { bf16* Q1; bf16* K1; bf16* V1;
    __device__ void operator()(int m, int n, float a) const {
        if (n < 4096) { const int c = rope_src(n); (c < 2048 ? Q1 : K1)[(size_t)m * 2048 + (c & 2047)] = f2bf_s(a); }
        else V1[(size_t)m * 2048 + n - 4096] = f2bf_s(a); } };
struct E5b { bf16* AP; __device__ void operator()(int m, int n, float a) const { bf16* p = AP + (size_t)m * 2048 + n; *p = f2bf_s(bf2f(*p) * silu_f(a)); } };

__global__ void __launch_bounds__(256) gla_alpha(const float* LOW, const float* w_g2, const float* b_g, float* alpha) {
    const int idx = blockIdx.x * 256 + threadIdx.x; const int m = idx >> 9, c = idx & 511;
    float z = b_g[c];
#pragma unroll
    for (int r = 0; r < 16; ++r) z += LOW[(size_t)m * 16 + r] * w_g2[r * 512 + c];
    const float ls = fminf(z, 0.f) - log1pf(expf(-fabsf(z)));
    alpha[idx] = expf(ls * (1.0f / 16.0f));
}
__global__ void __launch_bounds__(64) gla_recur(const bf16* QK0, bf16* V0, const float* alpha) {
    const int b = blockIdx.x >> 5, h = (blockIdx.x >> 3) & 3, v = (blockIdx.x & 7) * 64 + threadIdx.x;
    float S[128];
#pragma unroll
    for (int k = 0; k < 128; ++k) S[k] = 0.f;
    for (int t = 0; t < T; ++t) {
        const size_t m = (size_t)b * T + t;
        const unsigned* qv = (const unsigned*)(QK0 + m * 1024 + h * 128); const unsigned* kv = (const unsigned*)(QK0 + m * 1024 + 512 + h * 128);
        const float* al = alpha + m * 512 + h * 128;
        bf16* vp = V0 + m * 2048 + h * 512 + v;
        const float vv = bf2f(*vp);
        float acc = 0.f;
#pragma unroll
        for (int k2 = 0; k2 < 64; ++k2) { const unsigned qw = qv[k2], kw = kv[k2];
            const float q0 = __builtin_bit_cast(float, qw << 16), q1 = __builtin_bit_cast(float, qw & 0xffff0000u), k0 = __builtin_bit_cast(float, kw << 16), k1 = __builtin_bit_cast(float, kw & 0xffff0000u);
            S[2 * k2] = S[2 * k2] * al[2 * k2] + k0 * vv; acc += q0 * S[2 * k2];
            S[2 * k2 + 1] = S[2 * k2 + 1] * al[2 * k2 + 1] + k1 * vv; acc += q1 * S[2 * k2 + 1]; }
        *vp = f2bf_s(acc);
    }
}
__global__ void __launch_bounds__(128) gla_post(bf16* V0, const bf16* G0, const float* norm_g) {
    __shared__ float red[128];
    const int m = blockIdx.x >> 2, h = blockIdx.x & 3, tid = threadIdx.x;
    float v[4]; float s = 0.f;
#pragma unroll
    for (int j = 0; j < 4; ++j) { v[j] = bf2f(V0[(size_t)m * 2048 + h * 512 + tid + 128 * j]); s += v[j] * v[j]; }
    red[tid] = s; __syncthreads();
    for (int w = 64; w > 0; w >>= 1) { if (tid < w) red[tid] += red[tid + w]; __syncthreads(); }
    const float rstd = 1.0f / sqrtf(red[0] / 512.f + RMS_EPS);
#pragma unroll
    for (int j = 0; j < 4; ++j) { const int i = tid + 128 * j; const size_t idx = (size_t)m * 2048 + h * 512 + i;
        V0[idx] = f2bf_s(v[j] * rstd * norm_g[i] * bf2f(G0[idx])); }
}
__global__ void __launch_bounds__(256) rms_res(const float* Y, const float* g, const float* res, float* out, const float* g2, bf16* xn) {
    __shared__ float red[256];
    const int row = blockIdx.x, tid = threadIdx.x;
    float v[4]; float s = 0.f;
#pragma unroll
    for (int j = 0; j < 4; ++j) { v[j] = Y[(size_t)row * D + tid + 256 * j]; s += v[j] * v[j]; }
    red[tid] = s; __syncthreads();
    for (int o = 128; o > 0; o >>= 1) { if (tid < o) red[tid] += red[tid + o]; __syncthreads(); }
    const float rstd = 1.0f / sqrtf(red[0] / D + RMS_EPS);
    __syncthreads();
    float s2 = 0.f;
#pragma unroll
    for (int j = 0; j < 4; ++j) { const int i = tid + 256 * j; v[j] = res[(size_t)row * D + i] + v[j] * rstd * g[i]; out[(size_t)row * D + i] = v[j]; s2 += v[j] * v[j]; }
    if (xn) {
        red[tid] = s2; __syncthreads();
        for (int o = 128; o > 0; o >>= 1) { if (tid < o) red[tid] += red[tid + o]; __syncthreads(); }
        const float r2 = 1.0f / sqrtf(red[0] / D + RMS_EPS);
#pragma unroll
        for (int j = 0; j < 4; ++j) { const int i = tid + 256 * j; xn[(size_t)row * D + i] = f2bf_s(v[j] * r2 * g2[i]); }
    }
}
__global__ void __launch_bounds__(256) rope_k(bf16* Q1, bf16* K1, const float* ROPE) {
    const size_t idx = (size_t)blockIdx.x * 256 + threadIdx.x;
    const int j = idx & 31, c = (idx >> 5) & 1, hd = (idx >> 6) & 15, which = (idx >> 10) & 1; const size_t m = idx >> 11; const int pos = (int)(m & (T - 1));
    const float cs = ROPE[pos * 32 + j], sn = ROPE[T * 32 + pos * 32 + j];
    bf16* p = (which ? K1 : Q1) + m * 2048 + hd * 128 + c * 64 + j;
    const float x1 = bf2f(p[0]), x2 = bf2f(p[32]); const float sc = which ? 1.f : ATT_C2;
    p[0] = f2bf_s((x1 * cs - x2 * sn) * sc); p[32] = f2bf_s((x2 * cs + x1 * sn) * sc);
}
__global__ void __launch_bounds__(128) attn(bf16* Q1, const bf16* K1, const bf16* V1, const float* lq1, const float* lk1, const float* lq2, const float* lk2, const float* norm_g, float lambda_init) {
    __shared__ float O1s[64][129];
    const int qt = blockIdx.x, h = blockIdx.y, b = blockIdx.z; const int c = threadIdx.x >> 6, r = threadIdx.x & 63;
    const int t = qt * 64 + r; const size_t m = (size_t)b * T + t;
    float q[64];
#pragma unroll
    for (int d = 0; d < 64; ++d) q[d] = bf2f(Q1[m * 2048 + h * 128 + c * 64 + d]);
    float O[128];
#pragma unroll
    for (int d = 0; d < 128; ++d) O[d] = 0.f;
    float mx = -INFINITY, l = 0.f;
    const int jend = qt * 64 + 64;
    for (int j = 0; j < jend; ++j) {
        const size_t mj = (size_t)b * T + j;
        const bf16* kr = K1 + mj * 2048 + h * 128 + c * 64; const bf16* vr = V1 + mj * 2048 + h * 128;
        float s = 0.f;
#pragma unroll
        for (int d = 0; d < 64; ++d) s += q[d] * bf2f(kr[d]);
        const bool ok = (j <= t);
        const float mn = ok ? fmaxf(mx, s) : mx;
        const float sc = exp2f(mx - mn);
        const float p = ok ? exp2f(s - mn) : 0.f;
        l = l * sc + p;
#pragma unroll
        for (int d = 0; d < 128; ++d) O[d] = O[d] * sc + p * bf2f(vr[d]);
        mx = mn;
    }
    const float il = 1.0f / l;
    if (c == 1) {
#pragma unroll
        for (int d = 0; d < 128; ++d) O1s[r][d] = O[d] * il; }
    __syncthreads();
    if (c == 0) {
        float s1 = 0.f, s2 = 0.f;
        for (int i = 0; i < 64; ++i) { s1 += lq1[i] * lk1[i]; s2 += lq2[i] * lk2[i]; }
        const float lam = expf(s1) - expf(s2) + lambda_init;
        float ss = 0.f;
#pragma unroll
        for (int d = 0; d < 128; ++d) { O[d] = O[d] * il - lam * O1s[r][d]; ss += O[d] * O[d]; }
        const float rstd = 1.0f / sqrtf(ss / 128.f + RMS_EPS);
#pragma unroll
        for (int d = 0; d < 128; ++d) Q1[m * 2048 + h * 128 + d] = f2bf_s(O[d] * rstd * norm_g[d] * (1.0f - lambda_init));
    }
}
}
struct Args { const float* in[15]; float* out; unsigned char* ws; int ph_lo, ph_hi, li, pad; };
__global__ void __launch_bounds__(NWAVES * 64, 2) mk_fwd(Args args) {
    extern __shared__ __attribute__((aligned(16))) unsigned char lds[];
    Frame F;
    F.lds = (LAS unsigned char*)lds;
    F.MISC = (volatile LAS unsigned*)(F.lds + MISC_OFF);
    F.tid = threadIdx.x; F.lane = F.tid & 63; F.wave = __builtin_amdgcn_readfirstlane(F.tid >> 6);
    F.G = gridDim.x; { const int bx = blockIdx.x; F.vcu = (F.G % 8 == 0) ? (bx % 8) * (F.G / 8) + bx / 8 : bx; }
    unsigned char* ws = args.ws; F.ws = ws;
    F.ctl = (gu32*)(ws + WS_CTL);
    F.x = args.in[0]; F.pre_g = args.in[1]; F.post_g = args.in[2]; F.gla_w_in = args.in[3]; F.gla_w_g2 = args.in[4]; F.gla_b_g = args.in[5]; F.gla_norm_g = args.in[6];
    F.gla_w_out = args.in[7]; F.diff_w_in = args.in[8]; F.lq1 = args.in[9]; F.lk1 = args.in[10]; F.lq2 = args.in[11]; F.lk2 = args.in[12]; F.diff_norm_g = args.in[13]; F.diff_w_out = args.in[14];
    F.out = args.out;
    F.W0IN = (bf16*)(ws + WS_W0IN); F.W0OUT = (bf16*)(ws + WS_W0OUT); F.W1IN = (bf16*)(ws + WS_W1IN); F.W1OUT = (bf16*)(ws + WS_W1OUT);
    F.XN = (bf16*)(ws + WS_XN); F.QK0 = (bf16*)(ws + WS_QK0); F.V0 = (bf16*)(ws + WS_V0); F.G0 = (bf16*)(ws + WS_G0);
    F.Q1 = (bf16*)(ws + WS_Q1); F.K1 = (bf16*)(ws + WS_K1); F.V1 = (bf16*)(ws + WS_V1);
    F.ROPE = (float*)(ws + WS_ROPE); F.SSQ = (float*)(ws + WS_SSQ); F.LOW = (float*)(ws + WS_LOW);
    for (int u = F.tid; u < (LDS_BYTES - LDSCTL_OFF) / 4; u += NWAVES * 64) ((LAS unsigned*)(F.lds + LDSCTL_OFF))[u] = 0u;
    __syncthreads();
    XcdBarrier bar = xcd_barrier_post((unsigned*)(F.ctl + CW_BAR) + args.li * XCD_BAR_WORDS, F.MISC + 8);
    const int lo = args.ph_lo, hi = args.ph_hi;
#define IN(k) (lo <= (k) && (k) < hi)
#define BOTH(k) (IN(k) && IN((k) + 1))
    if (IN(0)) { p0_prologue(F); if (BOTH(0)) xcd_barrier(bar); }
#undef IN
#undef BOTH
}

extern "C" void kernel_launch(void* const* d_in, const int* in_sizes, int n_in, void* d_out, int out_size, void* d_ws, size_t ws_size, hipStream_t stream) {
    static int grid = 0;
    if (grid == 0) {
        if (n_in != 15 || in_sizes[0] != M * D || out_size != M * D || ws_size < WS_END) { fprintf(stderr, "kernel_launch: unexpected shapes / workspace (%d inputs, ws %zu)\n", n_in, ws_size); grid = -1; return; }
        int dev = 0, cus = 0, per_cu = 0;
        if (hipGetDevice(&dev) != hipSuccess || hipDeviceGetAttribute(&cus, hipDeviceAttributeMultiprocessorCount, dev) != hipSuccess) { grid = -1; return; }
        if (hipFuncSetAttribute((const void*)mk_fwd, hipFuncAttributeMaxDynamicSharedMemorySize, LDS_BYTES) != hipSuccess) { grid = -1; return; }
        if (hipOccupancyMaxActiveBlocksPerMultiprocessor(&per_cu, (const void*)mk_fwd, NWAVES * 64, LDS_BYTES) != hipSuccess || per_cu < 1) fprintf(stderr, "kernel_launch: occupancy query reports %d\n", per_cu);
        (void)hipGetLastError();
        grid = cus;
    }
    if (grid < 0) return;
    if (hipMemsetAsync((char*)d_ws + WS_CTL, 0, CTL_ZERO_BYTES, stream) != hipSuccess) return;
    Args a{};
    for (int i = 0; i < 15; ++i) a.in[i] = (const float*)d_in[i];
    a.out = (float*)d_out; a.ws = (unsigned char*)d_ws;
    unsigned char* ws = (unsigned char*)d_ws;
    bf16 *W0IN = (bf16*)(ws + WS_W0IN), *W0OUT = (bf16*)(ws + WS_W0OUT), *W1IN = (bf16*)(ws + WS_W1IN), *W1OUT = (bf16*)(ws + WS_W1OUT), *XN = (bf16*)(ws + WS_XN);
    bf16 *QK0 = (bf16*)(ws + WS_QK0), *V0 = (bf16*)(ws + WS_V0), *G0 = (bf16*)(ws + WS_G0), *Q1 = (bf16*)(ws + WS_Q1), *K1 = (bf16*)(ws + WS_K1), *V1 = (bf16*)(ws + WS_V1);
    float *ROPE = (float*)(ws + WS_ROPE), *LOW = (float*)(ws + WS_LOW);
    const float* x = a.in[0]; const float* pre_g = a.in[1]; const float* post_g = a.in[2]; float* out = (float*)d_out;
    const float lambda_init = (float)(0.8 - 0.6 * exp(-0.3 * 1.0));
    int li = 0;
    auto launch = [&](int lo, int hi) { a.ph_lo = lo; a.ph_hi = hi; a.li = li++; hipLaunchKernelGGL(mk_fwd, dim3(grid), dim3(NWAVES * 64), LDS_BYTES, stream, a); };
    launch(0, 1);
    nv::ngemm<<<dim3(GLA_INP / 64, M / 64), 256, 0, stream>>>(XN, W0IN, D, nv::E1{QK0, V0, G0, LOW});
    float* ALPHA = (float*)(ws + 440 * MiB);
    nv::gla_alpha<<<M * 512 / 256, 256, 0, stream>>>(LOW, a.in[4], a.in[5], ALPHA);
    nv::gla_recur<<<256, 64, 0, stream>>>(QK0, V0, ALPHA);
    nv::gla_post<<<M * 4, 128, 0, stream>>>(V0, G0, a.in[6]);
    float* Y0 = (float*)(ws + WS_G0);
    nv::ngemm<<<dim3(D / 64, M / 64), 256, 0, stream>>>(V0, W0OUT, BR, nv::EY{Y0});
    nv::rms_res<<<M, 256, 0, stream>>>(Y0, post_g, x, out, pre_g + D, XN);
    nv::ngemm<<<dim3(6144 / 64, M / 64), 256, 0, stream>>>(XN, W1IN, D, nv::E4{Q1, K1, V1});
    nv::rope_k<<<(unsigned)((size_t)M * 2048 / 256), 256, 0, stream>>>(Q1, K1, ROPE);
    nv::attn<<<dim3(T / 64, 16, NB), 128, 0, stream>>>(Q1, K1, V1, a.in[9], a.in[10], a.in[11], a.in[12], a.in[13], lambda_init);
    nv::ngemm<<<dim3(2048 / 64, M / 64), 256, 0, stream>>>(XN, W1IN + (size_t)6144 * D, D, nv::E5b{Q1});
    float* Y1 = (float*)(ws + WS_K1);
    nv::ngemm<<<dim3(D / 64, M / 64), 256, 0, stream>>>(Q1, W1OUT, BR, nv::EY{Y1});
    nv::rms_res<<<M, 256, 0, stream>>>(Y1, post_g + D, out, out, nullptr, nullptr);
}
```
